# Optimizing an MI355X kernel written in HIP

```python
import math
import jax, jax.numpy as jnp
from jax import lax
import numpy as np

D_MODEL = 1024
BATCH = 8
SEQ = 2048
DEPTH = 2
DEC_BATCH = 128
DEC_SEQ = 8
PAST_LEN = 16384
PAGE_SIZE = 128

N_MIXERS = 2
N_GLA = (DEPTH + 1) // 2
N_CMLP = DEPTH // 2
GLA_HEADS = 4
GLA_DK = D_MODEL // 2 // GLA_HEADS
GLA_DV = D_MODEL // GLA_HEADS
GLA_KW = GLA_HEADS * GLA_DK
GLA_VW = GLA_HEADS * GLA_DV
GLA_GATE_RANK = 16
GLA_GATE_TAU = 16.0
GLA_CHUNK = 64
GLA_IN_WIDTH = 2 * GLA_KW + 2 * GLA_VW + GLA_GATE_RANK
CMLP_WIDTH = D_MODEL
CMLP_GROUPS = 4
CMLP_GROUP_DIM = CMLP_WIDTH // CMLP_GROUPS
CMLP_CHUNK = 128
EPS = 1e-6

kernel_name = "hybrid_gla_chunkmlp_decode_step"


def rmsnorm(x, g):
    xf = x.astype(jnp.float32)
    y = xf * lax.rsqrt(jnp.mean(xf * xf, axis=-1, keepdims=True) + EPS)
    return (y * g.astype(jnp.float32)).astype(x.dtype)


def layernorm(x, g, b):
    xf = x.astype(jnp.float32)
    mu = jnp.mean(xf, axis=-1, keepdims=True)
    var = jnp.mean(jnp.square(xf - mu), axis=-1, keepdims=True)
    y = (xf - mu) * lax.rsqrt(var + EPS)
    return (y * g.astype(jnp.float32) + b.astype(jnp.float32)).astype(x.dtype)


def gla_chunked(q, k, v, log_a, s0, chunk):
    b, t, h, dk = q.shape
    dv = v.shape[-1]
    n = t // chunk

    def to_chunks(z):
        return z.astype(jnp.float32).reshape(b, n, chunk, h, z.shape[-1]).transpose(1, 0, 3, 2, 4)

    qc, kc, vc, ac = to_chunks(q), to_chunks(k), to_chunks(v), to_chunks(log_a)
    causal = jnp.tril(jnp.ones((chunk, chunk), dtype=bool))

    def step(state, inp):
        qi, ki, vi, ai = inp
        cum = jnp.cumsum(ai, axis=2)
        diff = cum[:, :, :, None, :] - cum[:, :, None, :, :]
        decay = jnp.exp(jnp.where(causal[:, :, None], diff, -jnp.inf))
        scores = jnp.einsum('bhtd,bhsd,bhtsd->bhts', qi, ki, decay)
        o_intra = jnp.einsum('bhts,bhsv->bhtv', scores, vi)
        o_inter = jnp.einsum('bhtd,bhdv->bhtv', qi * jnp.exp(cum), state)
        last = cum[:, :, -1:, :]
        k_dec = ki * jnp.exp(last - cum)
        new_state = jnp.exp(last[:, :, 0, :])[..., None] * state + jnp.einsum('bhsd,bhsv->bhdv', k_dec, vi)
        return new_state, o_intra + o_inter

    s_final, o = lax.scan(step, s0.astype(jnp.float32), (qc, kc, vc, ac))
    o = o.transpose(1, 0, 3, 2, 4).reshape(b, t, h, dv)
    return o, s_final


def gla_mixer(h, s0, w_in, w_a_up, b_a_up, g_onorm, w_out):
    bsz, t, _ = h.shape
    proj = h @ w_in
    q, k, v, gate, a_low = jnp.split(
        proj, [GLA_KW, 2 * GLA_KW, 2 * GLA_KW + GLA_VW, 2 * GLA_KW + 2 * GLA_VW], axis=-1)
    q = q.reshape(bsz, t, GLA_HEADS, GLA_DK) * (GLA_DK ** -0.5)
    k = k.reshape(bsz, t, GLA_HEADS, GLA_DK)
    v = v.reshape(bsz, t, GLA_HEADS, GLA_DV)
    gate_logit = (a_low @ w_a_up + b_a_up).astype(jnp.float32)
    log_a = (jax.nn.log_sigmoid(gate_logit) / GLA_GATE_TAU).reshape(bsz, t, GLA_HEADS, GLA_DK)
    o, s_new = gla_chunked(q, k, v, log_a, s0, math.gcd(t, GLA_CHUNK))
    o = rmsnorm(o, g_onorm).astype(h.dtype)
    o = o.reshape(bsz, t, GLA_VW) * jax.nn.silu(gate)
    return o @ w_out, s_new


def cmlp_mixer(h, w_in, ln_g, ln_b, w_spatial, b_spatial, w_out):
    bsz, t, _ = h.shape
    u, v, gate = jnp.split(h @ w_in, 3, axis=-1)
    v = layernorm(v, ln_g, ln_b)
    c = min(t, CMLP_CHUNK)
    n = t // c
    mask = jnp.tril(jnp.ones((c, c), dtype=w_spatial.dtype))
    ws = w_spatial[:, :c, :c] * mask
    bs = b_spatial[:, :c]
    vg = v.reshape(bsz, n, c, CMLP_GROUPS, CMLP_GROUP_DIM)
    mixed = jnp.einsum('gts,bnsgd->bntgd', ws, vg) + bs.T[:, :, None]
    z = u * mixed.reshape(bsz, t, CMLP_WIDTH) * jax.nn.silu(gate)
    return z @ w_out, v


def trunk(x, gla_states, norm_g, gla_w_in, gla_w_a_up, gla_b_a_up, gla_g_onorm, gla_w_out,
          cmlp_w_in, cmlp_ln_g, cmlp_ln_b, cmlp_w_spatial, cmlp_b_spatial, cmlp_w_out, norm_final):
    new_gla, new_v = [], []
    for i in range(DEPTH):
        h = rmsnorm(x, norm_g[i])
        j = i // N_MIXERS
        if i % N_MIXERS == 0:
            y, s = gla_mixer(h, gla_states[j], gla_w_in[j], gla_w_a_up[j], gla_b_a_up[j],
                             gla_g_onorm[j], gla_w_out[j])
            new_gla.append(s)
        else:
            y, vrows = cmlp_mixer(h, cmlp_w_in[j], cmlp_ln_g[j], cmlp_ln_b[j], cmlp_w_spatial[j],
                                  cmlp_b_spatial[j], cmlp_w_out[j])
            new_v.append(vrows)
        x = x + y
    return rmsnorm(x, norm_final), jnp.stack(new_gla), jnp.stack(new_v)


def setup_inputs(seed: int = 0) -> dict:
    key = jax.random.key(seed)
    ks = jax.random.split(key, 20)
    f32 = jnp.float32
    nrm = lambda k, s, sc: jax.random.normal(k, s, f32) * sc
    return {
        "x_prompt": nrm(ks[0], (BATCH, SEQ, D_MODEL), 1.0),
        "x_sample": nrm(ks[1], (DEC_BATCH, DEC_SEQ, D_MODEL), 1.0),
        "state_gla": nrm(ks[2], (N_GLA, DEC_BATCH, GLA_HEADS, GLA_DK, GLA_DV), 0.5),
        "norm_g": 1.0 + nrm(ks[3], (DEPTH, D_MODEL), 0.02),
        "gla_w_in": nrm(ks[4], (N_GLA, D_MODEL, GLA_IN_WIDTH), D_MODEL ** -0.5),
        "gla_w_a_up": nrm(ks[5], (N_GLA, GLA_GATE_RANK, GLA_KW), GLA_GATE_RANK ** -0.5),
        "gla_b_a_up": nrm(ks[6], (N_GLA, GLA_KW), 0.1),
        "gla_g_onorm": 1.0 + nrm(ks[7], (N_GLA, GLA_DV), 0.02),
        "gla_w_out": nrm(ks[8], (N_GLA, GLA_VW, D_MODEL), GLA_VW ** -0.5),
        "cmlp_w_in": nrm(ks[9], (N_CMLP, D_MODEL, 3 * CMLP_WIDTH), D_MODEL ** -0.5),
        "cmlp_ln_g": 1.0 + nrm(ks[10], (N_CMLP, CMLP_WIDTH), 0.02),
        "cmlp_ln_b": nrm(ks[11], (N_CMLP, CMLP_WIDTH), 0.02),
        "cmlp_w_spatial": nrm(ks[12], (N_CMLP, CMLP_GROUPS, CMLP_CHUNK, CMLP_CHUNK), CMLP_CHUNK ** -0.5),
        "cmlp_b_spatial": 1.0 + nrm(ks[13], (N_CMLP, CMLP_GROUPS, CMLP_CHUNK), 0.02),
        "cmlp_w_out": nrm(ks[14], (N_CMLP, CMLP_WIDTH, D_MODEL), CMLP_WIDTH ** -0.5),
        "norm_final": 1.0 + nrm(ks[15], (D_MODEL,), 0.02),
    }


def reference(x_prompt, x_sample, state_gla, norm_g, gla_w_in, gla_w_a_up, gla_b_a_up, gla_g_onorm,
              gla_w_out, cmlp_w_in, cmlp_ln_g, cmlp_ln_b, cmlp_w_spatial, cmlp_b_spatial, cmlp_w_out,
              norm_final):
    weights = (norm_g, gla_w_in, gla_w_a_up, gla_b_a_up, gla_g_onorm, gla_w_out,
               cmlp_w_in, cmlp_ln_g, cmlp_ln_b, cmlp_w_spatial, cmlp_b_spatial, cmlp_w_out, norm_final)
    zero_state = jnp.zeros((N_GLA, x_prompt.shape[0], GLA_HEADS, GLA_DK, GLA_DV), jnp.float32)
    y_prompt, gla_state_prompt, _ = trunk(x_prompt, zero_state, *weights)
    y_sample, gla_state_sample, cmlp_v_sample = trunk(x_sample, state_gla, *weights)
    return (y_prompt, y_sample, gla_state_prompt, gla_state_sample, cmlp_v_sample)
```

```cpp
#include <hip/hip_runtime.h>
#include <cstdio>
#include <cstdint>
#define MK_MODE 0
namespace pg8 {
#define PG8_LAS __attribute__((address_space(3)))
typedef unsigned short bf16_t;
typedef short bf16x8 __attribute__((ext_vector_type(8)));
typedef float f32x4 __attribute__((ext_vector_type(4)));
typedef unsigned u32x4 __attribute__((ext_vector_type(4)));
constexpr int BM = 256, BK = 64, HALF = 128, HTB = HALF * BK * 2  , STAGE_BYTES = 8 * HTB, NXCD = 8, WGM = 8;

__host__ __device__ __forceinline__ int lds_byte(int r, int c) { const int st = (r >> 4) * 2 + (c >> 5), rr = r & 15, cc = c & 31, ob = rr * 64 + cc * 2; return st * 1024 + (ob ^ (((ob >> 9) & 1) << 5)); }
__host__ __device__ __forceinline__ void stage_rc(int b, int& R, int& C) { const int st = b / 1024, sb = b % 1024, swz = sb ^ (((sb >> 9) & 1) << 5); R = (st >> 1) * 16 + swz / 64; C = (st & 1) * 32 + (swz % 64) / 2; }
__host__ __device__ __forceinline__ int perm32(int rho) { const int n = rho >> 4, i = rho & 15; return 8 * (i >> 2) + 4 * n + (i & 3); }

struct Unit { int pm, pn; };
struct Gemm { const bf16_t* A; const bf16_t* Bt; int M, N, K; };

struct StaticOrder {
    int nM, nN, nwg, G, c;
    __host__ __device__ void init(int M, int N, int G_, int c_) { nM = M / BM; nN = N / BM; nwg = nM * nN; G = G_; c = c_; }
    __host__ __device__ bool next(int i, Unit& u) const {
        const long L = (long)i * G + c; if (L >= nwg) return false;
        int wgid = (int)L; { const int q = nwg / NXCD, r = nwg % NXCD, xcd = wgid % NXCD, off = wgid / NXCD; wgid = (xcd < r ? xcd * (q + 1) : r * (q + 1) + (xcd - r) * q) + off; }
        const int nig = WGM * nN, gid = wgid / nig, fm = gid * WGM, gsz = (nM - fm) < WGM ? (nM - fm) : WGM;
        u.pm = fm + ((wgid % nig) % gsz); u.pn = (wgid % nig) / gsz; return true;
    }
    __device__ __forceinline__ void a_ready(const Unit&) const {}
    __device__ __forceinline__ void done(const Unit&) const {}
};
__device__ __forceinline__ unsigned cvt_pk_bf16(float lo, float hi) { unsigned r; asm volatile("v_cvt_pk_bf16_f32 %0, %1, %2" : "=v"(r) : "v"(lo), "v"(hi)); return r; }
typedef float f32x2 __attribute__((ext_vector_type(2)));
template <class Epi, class Sched, bool ALIGN_EPI = false, bool SP2 = false>
__device__ __forceinline__ void gemm_phase(PG8_LAS unsigned char* lds, const Gemm g, const Sched& S, const Epi& E) {
    const int tid = threadIdx.x, wid = __builtin_amdgcn_readfirstlane(tid >> 6), lane = tid & 63, wr = wid >> 2, wc = wid & 3, fr = lane & 15, fq = lane >> 4;
    const int K = g.K, nt = K / BK;
    unsigned voffA[2], voffB[2];
#pragma unroll
    for (int i = 0; i < 2; ++i) { int R, C; stage_rc(tid * 16 + i * 8192, R, C); const int Rb = Epi::PERM ? ((R & ~31) + perm32(R & 31)) : R;
        voffA[i] = (unsigned)(R * K + C) * 2u; voffB[i] = (unsigned)(Rb * K + C) * 2u; }
    const size_t kstep = (size_t)(BK * 2);
    const size_t hstep = (size_t)HALF * K * 2;
    const size_t tstep = 2 * hstep;
    const unsigned ldsw = (unsigned)wid * 1024u;
    const int aoff = lds_byte(wr * 64 + fr, fq * 8), boff = lds_byte(wc * 32 + fr, fq * 8);
#define PG8_SA(b, h) (((b) * 2 + (h)) * HTB)
#define PG8_SB(b, h) ((4 + (b) * 2 + (h)) * HTB)
#define PG8_STAGE(bufoff, gbase, voff) do { _Pragma("unroll") for (int _i = 0; _i < 2; ++_i) \
        __builtin_amdgcn_global_load_lds((const unsigned*)((const char*)(gbase) + (voff)[_i]), (PG8_LAS unsigned*)(lds + (bufoff) + ldsw + _i * 8192), 16, 0, 0); } while (0)
#define PG8_LDA(dst, b, h) do { _Pragma("unroll") for (int m = 0; m < 4; ++m) _Pragma("unroll") for (int k = 0; k < 2; ++k) dst[m][k] = *(const PG8_LAS bf16x8*)(lds + PG8_SA(b, h) + aoff + m * 2048 + k * 1024); } while (0)
#define PG8_LDB(dst, b, h) do { _Pragma("unroll") for (int n = 0; n < 2; ++n) _Pragma("unroll") for (int k = 0; k < 2; ++k) dst[n][k] = *(const PG8_LAS bf16x8*)(lds + PG8_SB(b, h) + boff + n * 2048 + k * 1024); } while (0)
#define PG8_MMA(ai, bj, At, Bt) do { __builtin_amdgcn_s_setprio(1); _Pragma("unroll") for (int m = 0; m < 4; ++m) _Pragma("unroll") for (int n = 0; n < 2; ++n) _Pragma("unroll") for (int k = 0; k < 2; ++k) \
        acc[ai][bj][m][n] = __builtin_amdgcn_mfma_f32_16x16x32_bf16(Bt[n][k], At[m][k], acc[ai][bj][m][n], 0, 0, 0); __builtin_amdgcn_s_setprio(0); } while (0)
#define PG8_WAIT_V(n) asm volatile("s_waitcnt vmcnt(" #n ")" ::: "memory")
#define PG8_WAIT_L(n) asm volatile("s_waitcnt lgkmcnt(" #n ")" ::: "memory")
#define PG8_BAR __builtin_amdgcn_s_barrier()
#define PG8_SCHED __builtin_amdgcn_sched_barrier(0)
    Unit cur, nxt; int ui = 0;
    if (!S.next(0, cur)) return;
    f32x4 acc[2][2][4][2];
#pragma unroll
    for (int a = 0; a < 2; ++a)
#pragma unroll
        for (int b = 0; b < 2; ++b)
#pragma unroll
            for (int m = 0; m < 4; ++m)
#pragma unroll
                for (int n = 0; n < 2; ++n) acc[a][b][m][n] = (f32x4){0.f, 0.f, 0.f, 0.f};
    bf16x8 At[4][2], B0[2][2], B1[2][2];
    const char* cA = (const char*)g.A + (size_t)cur.pm * tstep; const char* cB = (const char*)g.Bt + (size_t)cur.pn * tstep;
    S.a_ready(cur);
    if constexpr (SP2) {
        PG8_STAGE(PG8_SB(0, 0), cB, voffB); PG8_STAGE(PG8_SB(0, 1), cB + hstep, voffB); PG8_STAGE(PG8_SA(0, 0), cA, voffA); PG8_STAGE(PG8_SA(0, 1), cA + hstep, voffA);
        if (wr == 1) PG8_BAR;
        PG8_WAIT_V(2); PG8_BAR;
        PG8_STAGE(PG8_SB(1, 0), cB + kstep, voffB); PG8_STAGE(PG8_SA(1, 0), cA + kstep, voffA); PG8_STAGE(PG8_SB(1, 1), cB + hstep + kstep, voffB);
        PG8_WAIT_V(6); PG8_BAR;
    } else {
        PG8_STAGE(PG8_SB(0, 0), cB, voffB); PG8_STAGE(PG8_SA(0, 0), cA, voffA); PG8_STAGE(PG8_SB(0, 1), cB + hstep, voffB); PG8_STAGE(PG8_SA(0, 1), cA + hstep, voffA);
        if (wr == 1) PG8_BAR;
        PG8_WAIT_V(4); PG8_BAR;
        PG8_STAGE(PG8_SB(1, 0), cB + kstep, voffB); PG8_STAGE(PG8_SA(1, 0), cA + kstep, voffA); PG8_STAGE(PG8_SB(1, 1), cB + hstep + kstep, voffB);
        PG8_WAIT_V(6); PG8_BAR;
    }
    for (;;) {
        const bool has_next = S.next(ui + 1, nxt);
        const char* nA = has_next ? (const char*)g.A + (size_t)nxt.pm * tstep : cA; const char* nB = has_next ? (const char*)g.Bt + (size_t)nxt.pn * tstep : cB;
        for (int t = 0; t < nt; t += 2) {
            const bool last = (t == nt - 2);
            const char* a1 = cA + (size_t)(t + 1) * kstep;
            const char* a2 = last ? nA : cA + (size_t)(t + 2) * kstep; const char* b2 = last ? nB : cB + (size_t)(t + 2) * kstep;
            const char* a3 = a2 + kstep; const char* b3 = b2 + kstep;
            if (last && has_next) S.a_ready(nxt);
            if constexpr (SP2) {
            PG8_LDB(B0, 0, 0); PG8_LDB(B1, 0, 1); PG8_SCHED; PG8_LDA(At, 0, 0); PG8_STAGE(PG8_SA(1, 1), a1 + hstep, voffA);
            PG8_WAIT_V(8); PG8_WAIT_L(0); PG8_BAR; PG8_MMA(0, 0, At, B0); PG8_MMA(0, 1, At, B1); PG8_BAR; PG8_SCHED;
            PG8_LDA(At, 0, 1); PG8_STAGE(PG8_SB(0, 0), b2, voffB); PG8_STAGE(PG8_SB(0, 1), b2 + hstep, voffB); PG8_STAGE(PG8_SA(0, 0), a2, voffA);
            PG8_WAIT_V(8); PG8_WAIT_L(0); PG8_BAR; PG8_MMA(1, 0, At, B0); PG8_MMA(1, 1, At, B1); PG8_BAR; PG8_SCHED;
            PG8_LDB(B0, 1, 0); PG8_LDB(B1, 1, 1); PG8_SCHED; PG8_LDA(At, 1, 0); PG8_STAGE(PG8_SA(0, 1), a2 + hstep, voffA);
            PG8_WAIT_V(8); PG8_WAIT_L(0); PG8_BAR; PG8_MMA(0, 0, At, B0); PG8_MMA(0, 1, At, B1); PG8_BAR; PG8_SCHED;
            PG8_LDA(At, 1, 1); PG8_STAGE(PG8_SB(1, 0), b3, voffB); PG8_STAGE(PG8_SB(1, 1), b3 + hstep, voffB); PG8_STAGE(PG8_SA(1, 0), a3, voffA);
            PG8_WAIT_V(8); PG8_WAIT_L(0); PG8_BAR; PG8_MMA(1, 0, At, B0); PG8_MMA(1, 1, At, B1); PG8_BAR; PG8_SCHED;
            } else {
            PG8_LDB(B0, 0, 0); PG8_SCHED; PG8_LDA(At, 0, 0); PG8_STAGE(PG8_SA(1, 1), a1 + hstep, voffA);
            PG8_WAIT_L(8); PG8_BAR; PG8_WAIT_L(0); PG8_MMA(0, 0, At, B0); PG8_BAR; PG8_SCHED;
            PG8_LDB(B1, 0, 1); PG8_STAGE(PG8_SB(0, 0), b2, voffB);
            PG8_BAR; PG8_WAIT_L(0); PG8_MMA(0, 1, At, B1); PG8_BAR;
            PG8_LDA(At, 0, 1); PG8_STAGE(PG8_SA(0, 0), a2, voffA);
            PG8_BAR; PG8_WAIT_L(0); PG8_MMA(1, 0, At, B0); PG8_BAR; PG8_SCHED;
            PG8_STAGE(PG8_SB(0, 1), b2 + hstep, voffB);
            PG8_WAIT_V(6); PG8_BAR; PG8_MMA(1, 1, At, B1); PG8_BAR;
            PG8_LDB(B0, 1, 0); PG8_SCHED; PG8_LDA(At, 1, 0); PG8_STAGE(PG8_SA(0, 1), a2 + hstep, voffA);
            PG8_WAIT_L(8); PG8_BAR; PG8_WAIT_L(0); PG8_MMA(0, 0, At, B0); PG8_BAR; PG8_SCHED;
            PG8_LDB(B1, 1, 1); PG8_STAGE(PG8_SB(1, 0), b3, voffB);
            PG8_BAR; PG8_WAIT_L(0); PG8_MMA(0, 1, At, B1); PG8_BAR;
            PG8_LDA(At, 1, 1); PG8_STAGE(PG8_SA(1, 0), a3, voffA);
            PG8_BAR; PG8_WAIT_L(0); PG8_MMA(1, 0, At, B0); PG8_BAR; PG8_SCHED;
            PG8_STAGE(PG8_SB(1, 1), b3 + hstep, voffB);
            PG8_WAIT_V(6); PG8_BAR; PG8_MMA(1, 1, At, B1); PG8_BAR;
            }
        }
        if constexpr (ALIGN_EPI) { if (wr == 0) PG8_BAR; }
        if constexpr (!Epi::AFTER_DRAIN) { E(acc, cur, wr, wc, fr, fq); S.done(cur); }
        if (!has_next) break;
#pragma unroll
        for (int a = 0; a < 2; ++a)
#pragma unroll
            for (int b = 0; b < 2; ++b)
#pragma unroll
                for (int m = 0; m < 4; ++m)
#pragma unroll
                    for (int n = 0; n < 2; ++n) acc[a][b][m][n] = (f32x4){0.f, 0.f, 0.f, 0.f};
        cur = nxt; cA = nA; cB = nB; ++ui;
        if constexpr (ALIGN_EPI) { if (wr == 1) PG8_BAR; }
    }
    PG8_WAIT_V(0);
    if constexpr (!ALIGN_EPI) { if (wr == 0) PG8_BAR; }
    PG8_BAR;
    if constexpr (Epi::AFTER_DRAIN) { E.fused(acc, cur, wr, wc, fr, fq, lds, wid, lane); S.done(cur); }
#undef PG8_SA
#undef PG8_SB
#undef PG8_STAGE
#undef PG8_LDA
#undef PG8_LDB
#undef PG8_MMA
#undef PG8_WAIT_V
#undef PG8_WAIT_L
#undef PG8_BAR
#undef PG8_SCHED
}
}
namespace mk {
using pg8::bf16x8; using pg8::f32x4; using pg8::u32x4;
typedef unsigned short bf16;
typedef unsigned u32x2 __attribute__((ext_vector_type(2)));
typedef float f32x2 __attribute__((ext_vector_type(2)));
typedef __bf16 bf16x2_t __attribute__((ext_vector_type(2)));
#define LAS __attribute__((address_space(3)))
#define GAS __attribute__((address_space(1)))
constexpr int M = 17408, MP = 16384, MS = 1024;
constexpr size_t MiB = 1u << 20, KiB = 1u << 10;
constexpr size_t WS_CTL = 0, CTL_ZERO_BYTES = 1 * MiB;
constexpr size_t WS_W1QKG = 1 * MiB, WS_W1V = 5 * MiB, WS_WO1 = 7 * MiB, WS_W2UG = 9 * MiB, WS_W2V = 13 * MiB, WS_WO2 = 15 * MiB, WS_SMALL = 17 * MiB;
constexpr size_t WS_XB = 34 * MiB, WS_Q = 68 * MiB, WS_K = 85 * MiB, WS_VT = 102 * MiB, WS_G = 136 * MiB, WS_O = 170 * MiB, WS_PF = 204 * MiB, WS_NAIVE = 212 * MiB;
constexpr size_t WS_QF = WS_XB, WS_KF = WS_XB + 16 * MiB, WS_X1B = WS_XB, WS_UG = WS_Q, WS_VT2 = WS_VT, WS_Z = WS_G;
constexpr size_t SM_RSTD0 = WS_SMALL, SM_ALOW = WS_SMALL + 128 * KiB, SM_WSB = WS_SMALL + 1280 * KiB, SM_C2 = WS_SMALL + 1408 * KiB, SM_EL = WS_SMALL + 1536 * KiB,
                 SM_QS = WS_SMALL + 2 * MiB, SM_KS = WS_SMALL + 4 * MiB, SM_ELS = WS_SMALL + 6 * MiB, SM_PS = WS_SMALL + 6 * MiB + 256 * KiB, SM_SSQ1P = WS_SMALL + 6 * MiB + 512 * KiB,
                 SM_VSTAT = WS_SMALL + 7 * MiB + 640 * KiB, SM_SSQ2P = WS_SMALL + 8 * MiB + 768 * KiB, SM_OSSQ = WS_SMALL + 10 * MiB;
static_assert(SM_OSSQ + (size_t)M * 256 <= WS_XB && SM_ALOW + (size_t)M * 64 <= SM_WSB && SM_SSQ1P + (size_t)M * 64 <= SM_VSTAT && SM_VSTAT + (size_t)M * 64 <= SM_SSQ2P && SM_SSQ2P + (size_t)M * 64 <= SM_OSSQ, "small map");
constexpr int CW_BAR = 4096;
constexpr int RING_BYTES = 131072, MISC_OFF = RING_BYTES, LDS_BYTES = 147456;
constexpr size_t OUT_YP = 0, OUT_YS = 16777216, OUT_SP = 17825792, OUT_SS = 18874368, OUT_VS = 35651584;

__device__ __forceinline__ unsigned pk2(float lo, float hi) { f32x2 v = {lo, hi}; bf16x2_t b = __builtin_convertvector(v, bf16x2_t); return __builtin_bit_cast(unsigned, b); }
__device__ __forceinline__ float bflo(unsigned w) { return __uint_as_float(w << 16); }
__device__ __forceinline__ float bfhi(unsigned w) { return __uint_as_float(w & 0xffff0000u); }
__device__ __forceinline__ float bf2f(bf16 b) { return __uint_as_float((unsigned)b << 16); }
__device__ __forceinline__ bf16x8 pack8(f32x4 a, f32x4 b) { u32x4 w; w.x = pk2(a.x, a.y); w.y = pk2(a.z, a.w); w.z = pk2(b.x, b.y); w.w = pk2(b.z, b.w); return __builtin_bit_cast(bf16x8, w); }
__device__ __forceinline__ u32x4 pack8u(f32x4 a, f32x4 b) { u32x4 w; w.x = pk2(a.x, a.y); w.y = pk2(a.z, a.w); w.z = pk2(b.x, b.y); w.w = pk2(b.z, b.w); return w; }
__device__ __forceinline__ float fsilu(float x) { return x * __builtin_amdgcn_rcpf(1.f + __expf(-x)); }
__device__ __forceinline__ float logsig(float x) { return fminf(x, 0.f) - __logf(1.f + __expf(-fabsf(x))); }
__device__ __forceinline__ float wave_sum(float v) {
#pragma unroll
    for (int o = 1; o < 64; o <<= 1) v += __shfl_xor(v, o);
    return v;
}
#define LDS_WAIT() asm volatile("s_waitcnt lgkmcnt(0)" ::: "memory")
#define VM_WAIT() asm volatile("s_waitcnt vmcnt(0)" ::: "memory")
#define MFMA16(a, b, c) __builtin_amdgcn_mfma_f32_16x16x32_bf16((a), (b), (c), 0, 0, 0)

#define XB_TMO      128
#define XB_XCNT(j)  (256  + 64 * (j))
#define XB_XSUB(j)  (1280 + 64 * (j))
#define XB_XGEN(j)  (2304 + 64 * (j))
#define XB_TOP      3328
#define XB_TOPGEN   3392
#define XCD_BAR_WORDS 3456
#define XB_SPIN_CAP (1u << 18)
__device__ __forceinline__ unsigned xb_ld(unsigned* p)              { return __hip_atomic_load(p, __ATOMIC_RELAXED, __HIP_MEMORY_SCOPE_AGENT); }
__device__ __forceinline__ unsigned xb_add(unsigned* p, unsigned v) { return __hip_atomic_fetch_add(p, v, __ATOMIC_RELAXED, __HIP_MEMORY_SCOPE_AGENT); }
__device__ __forceinline__ unsigned xb_xcc_id() { return (unsigned)__builtin_amdgcn_s_getreg((3 << 11) | 20) & 0xFu; }
#define XB_SPIN(cond, bar) do { unsigned _sp = 0; while (cond) { __builtin_amdgcn_s_sleep(1); \
    if ((++_sp & 255u) == 0u) { if (xb_ld(&(bar)[XB_TMO])) break; if (_sp > XB_SPIN_CAP) { atomicAdd(&(bar)[XB_TMO], 1u); break; } } } } while (0)
struct XcdBarrier { unsigned* bar; unsigned x; volatile LAS unsigned* st; };
__device__ __forceinline__ XcdBarrier xcd_barrier_post(unsigned* bar, volatile LAS unsigned* st) {
    XcdBarrier b; b.bar = bar; b.x = xb_xcc_id(); b.st = st;
    if (threadIdx.x == 0) (void)xb_add(&bar[XB_XCNT(b.x)], 1u);
    return b;
}
__device__ __forceinline__ void xcd_barrier_complete(unsigned* bar, unsigned x, unsigned& nloc, unsigned& nx) {
    const unsigned G = gridDim.x * gridDim.y * gridDim.z;
    unsigned sum, cnt, mine, sp = 0u;
    for (;;) {
        sum = 0u; cnt = 0u; mine = 0u;
#pragma unroll
        for (unsigned j = 0; j < 16; ++j) { const unsigned c = xb_ld(&bar[XB_XCNT(j)]); sum += c; cnt += (c > 0u) ? 1u : 0u; mine = (j == x) ? c : mine; }
        if (sum == G) break;
        __builtin_amdgcn_s_sleep(1);
        if ((++sp & 255u) == 0u) { if (xb_ld(&bar[XB_TMO])) break; if (sp > XB_SPIN_CAP) { atomicAdd(&bar[XB_TMO], 1u); break; } }
    }
    nloc = mine > 0u ? mine : 1u; nx = cnt > 0u ? cnt : 1u;
}
__device__ __forceinline__ void xcd_barrier(const XcdBarrier& b) {
    asm volatile("s_waitcnt vmcnt(0)" ::: "memory");
    __syncthreads();
    if (threadIdx.x == 0) {
        unsigned* bar = b.bar;
        __builtin_amdgcn_s_waitcnt(0);
        unsigned nloc = b.st[0], nx = b.st[1];
        if (nloc == 0u) { xcd_barrier_complete(bar, b.x, nloc, nx); b.st[0] = nloc; b.st[1] = nx; }
        const unsigned old = xb_add(&bar[XB_XSUB(b.x)], 1u);
        const unsigned gen = old / nloc;
        if (old + 1u == (gen + 1u) * nloc) {
            __builtin_amdgcn_fence(__ATOMIC_RELEASE, "agent");
            asm volatile("s_waitcnt vmcnt(0)" ::: "memory");
            const unsigned og = xb_add(&bar[XB_TOP], 1u);
            const unsigned tg = og / nx;
            if (og + 1u == (tg + 1u) * nx) xb_add(&bar[XB_TOPGEN], 1u);
            else XB_SPIN(xb_ld(&bar[XB_TOPGEN]) == tg, bar);
            __builtin_amdgcn_fence(__ATOMIC_ACQUIRE, "agent");
            xb_add(&bar[XB_XGEN(b.x)], 1u);
            asm volatile("s_waitcnt vmcnt(0)" ::: "memory");
        } else {
            XB_SPIN(xb_ld(&bar[XB_XGEN(b.x)]) == gen, bar);
            __builtin_amdgcn_fence(__ATOMIC_ACQUIRE, "agent");
            asm volatile("s_waitcnt vmcnt(0)" ::: "memory");
        }
    }
    __syncthreads();
}

struct Ctx {
    LAS unsigned char* lds;
    int tid, lane, wave, G, bx;
    const float *xp, *xs, *state, *norm_g, *w_in, *wup, *bup, *gon, *w_out, *cw_in, *lng, *lnb, *wsp, *bsp, *cw_out, *nf;
    float* out; unsigned char* ws;
};
#define WSP(T, off) ((T*)(C.ws + (off)))

__device__ __forceinline__ void p0_transpose_item(const float* W, int ldw, int srccol0, const float* gk, bf16* WT, int dstrow0, int k0, LAS float* scr, int lane) {
#pragma unroll 8
    for (int i = 0; i < 32; ++i) { const int kk = 2 * i + (lane >> 5); float v = W[(size_t)(k0 + kk) * ldw + srccol0 + (lane & 31)]; if (gk) v *= gk[k0 + kk]; scr[kk * 33 + (lane & 31)] = v; }
    LDS_WAIT(); asm volatile("" ::: "memory");
    const int c = lane & 7;
#pragma unroll
    for (int j = 0; j < 4; ++j) { const int n = (lane >> 3) + 8 * j; const LAS float* s = scr + (8 * c) * 33 + n;
        u32x4 o; o.x = pk2(s[0 * 33], s[1 * 33]); o.y = pk2(s[2 * 33], s[3 * 33]); o.z = pk2(s[4 * 33], s[5 * 33]); o.w = pk2(s[6 * 33], s[7 * 33]);
        *(u32x4*)(WT + (size_t)(dstrow0 + n) * 1024 + k0 + 8 * c) = o; }
    LDS_WAIT(); asm volatile("" ::: "memory");
}
__device__ __forceinline__ void phase0(const Ctx& C) {
    const int tid = C.tid, lane = C.lane, wave = C.wave;
    const int gw = C.bx * 8 + wave, NGW = C.G * 8;
#pragma unroll
    for (int i = 0; i < 4; ++i) { const int p = tid + 512 * i, ks = p >> 6, l = p & 63, n = l & 15, kb = 32 * ks + 8 * (l >> 4);
        float v[8];
#pragma unroll
        for (int j = 0; j < 8; ++j) v[j] = C.norm_g[kb + j] * C.w_in[(size_t)(kb + j) * 3088 + 3072 + n];
        u32x4 w; w.x = pk2(v[0], v[1]); w.y = pk2(v[2], v[3]); w.z = pk2(v[4], v[5]); w.w = pk2(v[6], v[7]);
        *(LAS u32x4*)(C.lds + p * 16) = w; }
    __syncthreads();
    bf16* XB = WSP(bf16, WS_XB); float* RSTD0 = WSP(float, SM_RSTD0); float* ALOW = WSP(float, SM_ALOW);
    for (int grp = gw; grp < M / 16; grp += NGW) {
        const int row0 = grp * 16, r = lane & 15, g = lane >> 4;
        const float* xr = (row0 < MP ? C.xp + (size_t)row0 * 1024 : C.xs + (size_t)(row0 - MP) * 1024) + (size_t)r * 1024 + 8 * g;
        bf16* xo = XB + (size_t)(row0 + r) * 1024 + 8 * g;
        f32x4 acc = {0.f, 0.f, 0.f, 0.f}; float ssq = 0.f;
#pragma unroll 8
        for (int ks = 0; ks < 32; ++ks) {
            const f32x4 a0 = *(const f32x4*)(xr + 32 * ks), a1 = *(const f32x4*)(xr + 32 * ks + 4);
            ssq += (a0.x * a0.x + a0.y * a0.y) + (a0.z * a0.z + a0.w * a0.w) + (a1.x * a1.x + a1.y * a1.y) + (a1.z * a1.z + a1.w * a1.w);
            const u32x4 w = pack8u(a0, a1);
            *(u32x4*)(xo + 32 * ks) = w;
            const bf16x8 bfr = *(const LAS bf16x8*)(C.lds + (ks * 64 + lane) * 16);
            acc = MFMA16(__builtin_bit_cast(bf16x8, w), bfr, acc);
        }
        ssq += __shfl_xor(ssq, 16); ssq += __shfl_xor(ssq, 32);
        const float rstd = rsqrtf(ssq * (1.f / 1024.f) + 1e-6f);
        if (g == 0) RSTD0[row0 + r] = rstd;
#pragma unroll
        for (int rr = 0; rr < 4; ++rr) { const float rs = __shfl(rstd, 4 * g + rr); ALOW[(size_t)(row0 + 4 * g + rr) * 16 + r] = acc[rr] * rs; }
    }
    LAS float* scr = (LAS float*)(C.lds + 32768 + wave * 8704);
    for (int it = gw; it < 4096; it += NGW) {
        int r = it;
        if (r < 1024) { const int nb = r & 63, kb = r >> 6, n0 = 32 * nb; p0_transpose_item(C.w_in, 3088, n0 < 1024 ? n0 : n0 + 1024, C.norm_g, WSP(bf16, WS_W1QKG), n0, 64 * kb, scr, lane); continue; } r -= 1024;
        if (r < 512)  { const int nb = r & 31, kb = r >> 5, n0 = 32 * nb; p0_transpose_item(C.w_in, 3088, 1024 + n0, C.norm_g, WSP(bf16, WS_W1V), n0, 64 * kb, scr, lane); continue; } r -= 512;
        if (r < 512)  { const int nb = r & 31, kb = r >> 5, n0 = 32 * nb; p0_transpose_item(C.w_out, 1024, n0, nullptr, WSP(bf16, WS_WO1), n0, 64 * kb, scr, lane); continue; } r -= 512;
        if (r < 1024) { const int nb = r & 63, kb = r >> 6, n0 = 32 * nb; const int pn = n0 >> 8, bj = (n0 >> 7) & 1, j = n0 & 127;
                        p0_transpose_item(C.cw_in, 3072, (bj ? 2048 : 0) + 128 * pn + j, C.norm_g + 1024, WSP(bf16, WS_W2UG), n0, 64 * kb, scr, lane); continue; } r -= 1024;
        if (r < 512)  { const int nb = r & 31, kb = r >> 5, n0 = 32 * nb; p0_transpose_item(C.cw_in, 3072, 1024 + n0, C.norm_g + 1024, WSP(bf16, WS_W2V), n0, 64 * kb, scr, lane); continue; } r -= 512;
        { const int nb = r & 31, kb = r >> 5, n0 = 32 * nb; p0_transpose_item(C.cw_out, 1024, n0, nullptr, WSP(bf16, WS_WO2), n0, 64 * kb, scr, lane); }
    }
    bf16* WSB = WSP(bf16, SM_WSB); float* C2 = WSP(float, SM_C2);
    for (int e = C.bx * 512 + tid; e < 65536; e += C.G * 512) { const int t = (e >> 7) & 127, s = e & 127; WSB[e] = (s <= t) ? (bf16)(pk2(C.wsp[e], 0.f) & 0xffffu) : (bf16)0; }
    for (int wv = gw; wv < 512; wv += NGW) { const int t = wv & 127; float s = 0.f;
        if (lane <= t) s += C.wsp[wv * 128 + lane]; if (lane + 64 <= t) s += C.wsp[wv * 128 + lane + 64];
        s = wave_sum(s); if (lane == 0) C2[wv] = s; }
}
template <class E8> struct Wrap8 {
    static constexpr bool PERM = true, AFTER_DRAIN = false; E8 e;
    __device__ __forceinline__ void operator()(const f32x4 (&acc)[2][2][4][2], const pg8::Unit& u, int wr, int wc, int fr, int fq) const {
        const int row0 = u.pm * 256 + wr * 64 + fr, col0 = u.pn * 256 + wc * 32 + 8 * fq;
#pragma unroll
        for (int ai = 0; ai < 2; ++ai)
#pragma unroll
            for (int m = 0; m < 4; ++m)
#pragma unroll
                for (int bj = 0; bj < 2; ++bj) e.piece8(row0 + ai * 128 + m * 16, col0 + bj * 128, acc[ai][bj][m][0], acc[ai][bj][m][1]);
    }
};
template <class E8> struct Wrap8P {
    static constexpr bool PERM = true, AFTER_DRAIN = false; E8 e;
    __device__ __forceinline__ void operator()(const f32x4 (&acc)[2][2][4][2], const pg8::Unit& u, int wr, int wc, int fr, int fq) const {
        const int row0 = u.pm * 256 + wr * 64 + fr, ch0 = u.pn * 128 + wc * 32 + 8 * fq;
#pragma unroll
        for (int ai = 0; ai < 2; ++ai)
#pragma unroll
            for (int m = 0; m < 4; ++m) e.pair8(row0 + ai * 128 + m * 16, ch0, acc[ai][0][m][0], acc[ai][0][m][1], acc[ai][1][m][0], acc[ai][1][m][1]);
    }
};
struct EpiQKG {
    const float* rstd0; bf16 *Q, *K, *G;
    __device__ __forceinline__ void piece8(int row, int col, f32x4 v0, f32x4 v1) const {
        const float rs = rstd0[row]; v0 = v0 * rs; v1 = v1 * rs; bf16* dst;
        if (col < 512) { v0 = v0 * 0.08838834764831845f; v1 = v1 * 0.08838834764831845f; dst = Q + (size_t)row * 512 + col; }
        else if (col < 1024) dst = K + (size_t)row * 512 + (col - 512);
        else { v0.x = fsilu(v0.x); v0.y = fsilu(v0.y); v0.z = fsilu(v0.z); v0.w = fsilu(v0.w); v1.x = fsilu(v1.x); v1.y = fsilu(v1.y); v1.z = fsilu(v1.z); v1.w = fsilu(v1.w);
               dst = G + (size_t)row * 1024 + (col - 1024); }
        *(u32x4*)dst = pack8u(v0, v1);
    }
};
struct EpiVT {
    const float* rstd0; bf16* VT;
    __device__ __forceinline__ void piece8(int row, int col, f32x4 v0, f32x4 v1) const {
        const f32x4 r0 = *(const f32x4*)(rstd0 + col), r1 = *(const f32x4*)(rstd0 + col + 4);
        *(u32x4*)(VT + (size_t)row * M + col) = pack8u(v0 * r0, v1 * r1);
    }
};
__device__ __forceinline__ float rstd_from16(const float* p16, float inv_n) {
    const f32x4 a = *(const f32x4*)p16, b = *(const f32x4*)(p16 + 4), c = *(const f32x4*)(p16 + 8), d = *(const f32x4*)(p16 + 12);
    const float s = ((a.x + a.y) + (a.z + a.w)) + ((b.x + b.y) + (b.z + b.w)) + ((c.x + c.y) + (c.z + c.w)) + ((d.x + d.y) + (d.z + d.w));
    return rsqrtf(s * inv_n + 1e-6f);
}
struct EpiUG {
    const float* ssq1p; bf16* UG;
    __device__ __forceinline__ void pair8(int row, int ch, f32x4 u0, f32x4 u1, f32x4 g0, f32x4 g1) const {
        const float rs = rstd_from16(ssq1p + (size_t)row * 16, 1.f / 1024.f);
        f32x4 a, b;
        a.x = u0.x * rs * fsilu(g0.x * rs); a.y = u0.y * rs * fsilu(g0.y * rs); a.z = u0.z * rs * fsilu(g0.z * rs); a.w = u0.w * rs * fsilu(g0.w * rs);
        b.x = u1.x * rs * fsilu(g1.x * rs); b.y = u1.y * rs * fsilu(g1.y * rs); b.z = u1.z * rs * fsilu(g1.z * rs); b.w = u1.w * rs * fsilu(g1.w * rs);
        *(u32x4*)(UG + (size_t)row * 1024 + ch) = pack8u(a, b);
    }
};
struct EpiVT2raw {
    bf16* VT2;
    __device__ __forceinline__ void piece8(int row, int col, f32x4 v0, f32x4 v1) const { *(u32x4*)(VT2 + (size_t)row * M + col) = pack8u(v0, v1); }
};
struct EpiVT2 {
    static constexpr bool PERM = true, AFTER_DRAIN = false; bf16* VT2; f32x2* VSTAT;
    __device__ __forceinline__ void operator()(const f32x4 (&acc)[2][2][4][2], const pg8::Unit& u, int wr, int wc, int fr, int fq) const {
        const int ch0 = u.pm * 256 + wr * 64 + fr, tok0 = u.pn * 256 + wc * 32 + 8 * fq;
#pragma unroll
        for (int ai = 0; ai < 2; ++ai)
#pragma unroll
            for (int m = 0; m < 4; ++m)
#pragma unroll
                for (int bj = 0; bj < 2; ++bj) *(u32x4*)(VT2 + (size_t)(ch0 + ai * 128 + m * 16) * M + tok0 + bj * 128) = pack8u(acc[ai][bj][m][0], acc[ai][bj][m][1]);
#pragma unroll
        for (int bj = 0; bj < 2; ++bj)
#pragma unroll
            for (int n = 0; n < 2; ++n)
#pragma unroll
                for (int c = 0; c < 4; ++c) {
                    float s = 0.f, q = 0.f;
#pragma unroll
                    for (int ai = 0; ai < 2; ++ai)
#pragma unroll
                        for (int m = 0; m < 4; ++m) { const float v = acc[ai][bj][m][n][c]; s += v; q += v * v; }
#pragma unroll
                    for (int o = 1; o < 16; o <<= 1) { s += __shfl_xor(s, o); q += __shfl_xor(q, o); }
                    if (fr == 0) VSTAT[(size_t)(tok0 + bj * 128 + 4 * n + c) * 8 + u.pm * 2 + wr] = (f32x2){s, q};
                }
    }
};
template <bool WITH_BF16> struct EpiRes {
    static constexpr bool PERM = false, AFTER_DRAIN = false; const float* base; float* XO; bf16* XOB; float* SSQP;
    __device__ __forceinline__ void operator()(const f32x4 (&acc)[2][2][4][2], const pg8::Unit& u, int wr, int wc, int fr, int fq) const {
        const int row0 = u.pm * 256 + wr * 64 + fr, col0 = u.pn * 256 + wc * 32 + 4 * fq;
#pragma unroll
        for (int ai = 0; ai < 2; ++ai)
#pragma unroll
            for (int m = 0; m < 4; ++m) { const int row = row0 + ai * 128 + m * 16; float ss = 0.f;
#pragma unroll
                for (int bj = 0; bj < 2; ++bj)
#pragma unroll
                    for (int n = 0; n < 2; ++n) { const size_t off = (size_t)row * 1024 + col0 + bj * 128 + n * 16;
                        const f32x4 v = acc[ai][bj][m][n] + *(const f32x4*)(base + off); *(f32x4*)(XO + off) = v;
                        if (WITH_BF16) { u32x2 w; w.x = pk2(v.x, v.y); w.y = pk2(v.z, v.w); *(u32x2*)(XOB + off) = w; }
                        ss += (v.x * v.x + v.y * v.y) + (v.z * v.z + v.w * v.w); }
                ss += __shfl_xor(ss, 16); ss += __shfl_xor(ss, 32);
                if (fq == 0) SSQP[(size_t)row * 16 + u.pn * 4 + wc] = ss; }
    }
};

template <int MT, int NG>
__device__ __forceinline__ void tail_mma(const bf16* A, const bf16* Bt, int m0, int nb0, int nbstride, int lane, f32x4 (&acc)[MT][NG][2]) {
    const int i = lane & 15, g = lane >> 4;
    const bf16* ap = A + (size_t)(m0 + i) * 1024 + 8 * g;
    const bf16* bp = Bt + (size_t)(nb0 + 8 * (i >> 2) + (i & 3)) * 1024 + 8 * g;
#pragma unroll
    for (int mt = 0; mt < MT; ++mt)
#pragma unroll
        for (int ng = 0; ng < NG; ++ng) { acc[mt][ng][0] = (f32x4){0.f, 0.f, 0.f, 0.f}; acc[mt][ng][1] = (f32x4){0.f, 0.f, 0.f, 0.f}; }
#pragma unroll 4
    for (int ks = 0; ks < 32; ++ks) {
        bf16x8 af[MT], bfr[NG][2];
#pragma unroll
        for (int mt = 0; mt < MT; ++mt) af[mt] = *(const bf16x8*)(ap + (size_t)mt * 16 * 1024 + 32 * ks);
#pragma unroll
        for (int ng = 0; ng < NG; ++ng)
#pragma unroll
            for (int n = 0; n < 2; ++n) bfr[ng][n] = *(const bf16x8*)(bp + ((size_t)ng * nbstride + 4 * n) * 1024 + 32 * ks);
#pragma unroll
        for (int mt = 0; mt < MT; ++mt)
#pragma unroll
            for (int ng = 0; ng < NG; ++ng)
#pragma unroll
                for (int n = 0; n < 2; ++n) acc[mt][ng][n] = MFMA16(bfr[ng][n], af[mt], acc[mt][ng][n]);
    }
}
template <class E8>
__device__ __forceinline__ void tail_tile_p8(const bf16* A, const bf16* Bt, int bm, int bn, int row_off, int col_off, int wave, int lane, const E8& e) {
    f32x4 acc[2][1][2];
    const int m0 = 64 * bm + 32 * (wave >> 2), nb0 = 128 * bn + 32 * (wave & 3);
    tail_mma<2, 1>(A, Bt, m0, nb0, 0, lane, acc);
    const int i = lane & 15, g = lane >> 4;
#pragma unroll
    for (int mt = 0; mt < 2; ++mt) e.piece8(row_off + m0 + 16 * mt + i, col_off + nb0 + 8 * g, acc[mt][0][0], acc[mt][0][1]);
}
template <class E8>
__device__ __forceinline__ void tail_tile_pair(const bf16* A, const bf16* Bt, int bm, int pn, int row_off, int wave, int lane, const E8& e) {
    f32x4 acc[2][2][2];
    const int m0 = 64 * bm + 32 * (wave >> 2), nb0 = 256 * pn + 32 * (wave & 3);
    tail_mma<2, 2>(A, Bt, m0, nb0, 128, lane, acc);
    const int i = lane & 15, g = lane >> 4;
#pragma unroll
    for (int mt = 0; mt < 2; ++mt) e.pair8(row_off + m0 + 16 * mt + i, 128 * pn + 32 * (wave & 3) + 8 * g, acc[mt][0][0], acc[mt][0][1], acc[mt][1][0], acc[mt][1][1]);
}
#ifndef MK_SP2
#define MK_SP2 true
#endif
#ifndef MK_ALIGN
#define MK_ALIGN true
#endif
__device__ __forceinline__ void phase1(const Ctx& C) {
    const float* RSTD0 = WSP(float, SM_RSTD0);
    { pg8::Gemm g{WSP(bf16, WS_XB), WSP(bf16, WS_W1QKG), MP, 2048, 1024}; pg8::StaticOrder S; S.init(MP, 2048, C.G, C.bx);
      Wrap8<EpiQKG> E{{RSTD0, WSP(bf16, WS_Q), WSP(bf16, WS_K), WSP(bf16, WS_G)}};
      pg8::gemm_phase<Wrap8<EpiQKG>, pg8::StaticOrder, MK_ALIGN, MK_SP2>(C.lds, g, S, E); }
    { pg8::Gemm g{WSP(bf16, WS_W1V), WSP(bf16, WS_XB), 1024, MP, 1024}; pg8::StaticOrder S; S.init(1024, MP, C.G, C.bx);
      Wrap8<EpiVT> E{{RSTD0, WSP(bf16, WS_VT)}};
      pg8::gemm_phase<Wrap8<EpiVT>, pg8::StaticOrder, MK_ALIGN, MK_SP2>(C.lds, g, S, E); }
    for (int t = C.bx; t < 384; t += C.G) {
        if (t < 256) { const EpiQKG e{RSTD0, WSP(bf16, WS_Q), WSP(bf16, WS_K), WSP(bf16, WS_G)};
            tail_tile_p8(WSP(bf16, WS_XB) + (size_t)MP * 1024, WSP(bf16, WS_W1QKG), t >> 4, t & 15, MP, 0, C.wave, C.lane, e); }
        else { const int u = t - 256; const EpiVT e{RSTD0, WSP(bf16, WS_VT)};
            tail_tile_p8(WSP(bf16, WS_W1V), WSP(bf16, WS_XB) + (size_t)MP * 1024, u >> 3, u & 7, 0, MP, C.wave, C.lane, e); }
    }
}

constexpr int P2A_QT = 0, P2A_KT = 17408, P2A_CUM = 34816, P2A_TOT = 67584, P2A_AL = 69632, QK_PITCH = 272;
__device__ __forceinline__ void p2a_prompt_item(const Ctx& C, int item) {
    const int tid = C.tid, lane = C.lane, wave = C.wave;
    const int b = item >> 7, h = (item >> 5) & 3, c = item & 31, R0 = b * 2048 + 64 * c;
    LAS unsigned char* L = C.lds;
    LAS float* AL = (LAS float*)(L + P2A_AL); LAS float* CUM = (LAS float*)(L + P2A_CUM); LAS float* TOT = (LAS float*)(L + P2A_TOT);
    if (tid < 256) *(LAS f32x4*)(AL + tid * 4) = *(const f32x4*)(WSP(float, SM_ALOW) + (size_t)R0 * 16 + tid * 4);
    const int d = tid & 127, tg = tid >> 7;
    float wu[16];
#pragma unroll
    for (int r = 0; r < 16; ++r) wu[r] = C.wup[r * 512 + h * 128 + d];
    const float bb = C.bup[h * 128 + d];
    __syncthreads();
    float cumv[16]; float run = 0.f;
#pragma unroll
    for (int i = 0; i < 16; ++i) { const int t = 16 * tg + i; float x = bb;
#pragma unroll
        for (int r4 = 0; r4 < 4; ++r4) { const f32x4 a = *(const LAS f32x4*)(AL + t * 16 + 4 * r4); x += a.x * wu[4 * r4] + a.y * wu[4 * r4 + 1] + a.z * wu[4 * r4 + 2] + a.w * wu[4 * r4 + 3]; }
        run += logsig(x) * (1.f / 16.f); cumv[i] = run; }
    TOT[tg * 128 + d] = run;
    __syncthreads();
    { const float t0 = TOT[d], t1 = TOT[128 + d], t2 = TOT[256 + d], t3 = TOT[384 + d];
      const float off = (tg > 0 ? t0 : 0.f) + (tg > 1 ? t1 : 0.f) + (tg > 2 ? t2 : 0.f);
      if (tg == 0) WSP(float, SM_EL)[(size_t)item * 128 + d] = __expf((t0 + t1) + (t2 + t3));
#pragma unroll
      for (int i = 0; i < 16; ++i) CUM[(16 * tg + i) * 128 + d] = off + cumv[i]; }
    __syncthreads();
    { const int t = tid >> 3, dc = (tid & 7) * 16;
      const bf16* qp = WSP(bf16, WS_Q) + (size_t)(R0 + t) * 512 + h * 128 + dc; const bf16* kp = WSP(bf16, WS_K) + (size_t)(R0 + t) * 512 + h * 128 + dc;
      const u32x4 q0 = *(const u32x4*)qp, q1 = *(const u32x4*)(qp + 8), k0 = *(const u32x4*)kp, k1 = *(const u32x4*)(kp + 8);
      const unsigned qw[8] = {q0.x, q0.y, q0.z, q0.w, q1.x, q1.y, q1.z, q1.w}, kw[8] = {k0.x, k0.y, k0.z, k0.w, k1.x, k1.y, k1.z, k1.w};
      unsigned qo[8], ko[8];
#pragma unroll
      for (int j4 = 0; j4 < 4; ++j4) { const f32x4 cv = *(const LAS f32x4*)(CUM + t * 128 + dc + 4 * j4);
          const float e0 = __expf(cv.x), e1 = __expf(cv.y), e2 = __expf(cv.z), e3 = __expf(cv.w);
          const float n0 = __expf(-cv.x), n1 = __expf(-cv.y), n2 = __expf(-cv.z), n3 = __expf(-cv.w);
          qo[2 * j4] = pk2(bflo(qw[2 * j4]) * e0, bfhi(qw[2 * j4]) * e1); qo[2 * j4 + 1] = pk2(bflo(qw[2 * j4 + 1]) * e2, bfhi(qw[2 * j4 + 1]) * e3);
          ko[2 * j4] = pk2(bflo(kw[2 * j4]) * n0, bfhi(kw[2 * j4]) * n1); ko[2 * j4 + 1] = pk2(bflo(kw[2 * j4 + 1]) * n2, bfhi(kw[2 * j4 + 1]) * n3); }
      *(LAS u32x4*)(L + P2A_QT + t * QK_PITCH + dc * 2) = (u32x4){qo[0], qo[1], qo[2], qo[3]}; *(LAS u32x4*)(L + P2A_QT + t * QK_PITCH + dc * 2 + 16) = (u32x4){qo[4], qo[5], qo[6], qo[7]};
      *(LAS u32x4*)(L + P2A_KT + t * QK_PITCH + dc * 2) = (u32x4){ko[0], ko[1], ko[2], ko[3]}; *(LAS u32x4*)(L + P2A_KT + t * QK_PITCH + dc * 2 + 16) = (u32x4){ko[4], ko[5], ko[6], ko[7]}; }
    __syncthreads();
    const int i = lane & 15, g = lane >> 4;
    { const int tt = wave >> 1, ks = wave & 1; f32x4 a0 = {0.f, 0.f, 0.f, 0.f}, a1 = {0.f, 0.f, 0.f, 0.f};
#pragma unroll
      for (int kd = 0; kd < 4; ++kd) { const bf16x8 qf = *(const LAS bf16x8*)(L + P2A_QT + (16 * tt + i) * QK_PITCH + (32 * kd + 8 * g) * 2);
          const bf16x8 kf0 = *(const LAS bf16x8*)(L + P2A_KT + (16 * (2 * ks) + i) * QK_PITCH + (32 * kd + 8 * g) * 2), kf1 = *(const LAS bf16x8*)(L + P2A_KT + (16 * (2 * ks + 1) + i) * QK_PITCH + (32 * kd + 8 * g) * 2);
          a0 = MFMA16(kf0, qf, a0); a1 = MFMA16(kf1, qf, a1); }
      const int t = 16 * tt + i, s0 = 32 * ks + 4 * g;
#pragma unroll
      for (int r = 0; r < 4; ++r) { if (s0 + r > t) a0[r] = 0.f; if (s0 + 16 + r > t) a1[r] = 0.f; }
      *(u32x4*)(WSP(bf16, WS_PF) + ((size_t)item * 512 + (tt * 2 + ks) * 64 + lane) * 8) = pack8u(a0, a1); }
#pragma unroll
    for (int it = 0; it < 2; ++it) { const int p = tid + 512 * it, f = p >> 6, l = p & 63, li = l & 15, lg = l >> 4;
        { const int tt = f >> 2, kd = f & 3; LAS unsigned char* src = L + P2A_QT + (16 * tt + li) * QK_PITCH + (32 * kd + 4 * lg) * 2;
          const u32x2 lo = *(const LAS u32x2*)src, hi = *(const LAS u32x2*)(src + 32);
          *(u32x4*)(WSP(bf16, WS_QF) + ((size_t)item * 1024 + p) * 8) = (u32x4){lo.x, lo.y, hi.x, hi.y}; }
        { const int dt = f >> 1, ks = f & 1; LAS unsigned char* src = L + P2A_KT + (32 * ks + 4 * lg) * QK_PITCH + (16 * dt + li) * 2;
          unsigned short e[8];
#pragma unroll
          for (int j = 0; j < 8; ++j) e[j] = *(const LAS unsigned short*)(src + (16 * (j >> 2) + (j & 3)) * QK_PITCH);
          *(u32x4*)(WSP(bf16, WS_KF) + ((size_t)item * 1024 + p) * 8) = (u32x4){(unsigned)e[0] | ((unsigned)e[1] << 16), (unsigned)e[2] | ((unsigned)e[3] << 16), (unsigned)e[4] | ((unsigned)e[5] << 16), (unsigned)e[6] | ((unsigned)e[7] << 16)}; }
    }
    __syncthreads();
}
__device__ __forceinline__ void p2a_sample_item(const Ctx& C, int item) {
    const int lane = C.lane, b = item >> 2, h = item & 3, R0 = MP + 8 * b;
    const float* AL = WSP(float, SM_ALOW) + (size_t)R0 * 16;
    float qt[2][8], kt[2][8];
#pragma unroll
    for (int e = 0; e < 2; ++e) { const int d = lane + 64 * e; float wu[16];
#pragma unroll
        for (int r = 0; r < 16; ++r) wu[r] = C.wup[r * 512 + h * 128 + d];
        const float bb = C.bup[h * 128 + d]; float cum = 0.f;
#pragma unroll
        for (int t = 0; t < 8; ++t) { float x = bb;
#pragma unroll
            for (int r = 0; r < 16; ++r) x += AL[t * 16 + r] * wu[r];
            cum += logsig(x) * (1.f / 16.f);
            qt[e][t] = bf2f(WSP(bf16, WS_Q)[(size_t)(R0 + t) * 512 + h * 128 + d]) * __expf(cum); kt[e][t] = bf2f(WSP(bf16, WS_K)[(size_t)(R0 + t) * 512 + h * 128 + d]) * __expf(-cum); }
        WSP(float, SM_ELS)[(size_t)item * 128 + d] = __expf(cum);
        float* qs = WSP(float, SM_QS) + ((size_t)item * 128 + d) * 8; float* ks = WSP(float, SM_KS) + ((size_t)item * 128 + d) * 8;
        *(f32x4*)qs = (f32x4){qt[e][0], qt[e][1], qt[e][2], qt[e][3]}; *(f32x4*)(qs + 4) = (f32x4){qt[e][4], qt[e][5], qt[e][6], qt[e][7]};
        *(f32x4*)ks = (f32x4){kt[e][0], kt[e][1], kt[e][2], kt[e][3]}; *(f32x4*)(ks + 4) = (f32x4){kt[e][4], kt[e][5], kt[e][6], kt[e][7]}; }
    float mine = 0.f;
#pragma unroll
    for (int t = 0; t < 8; ++t)
#pragma unroll
        for (int s = 0; s < 8; ++s) { if (s <= t) { const float v = wave_sum(qt[0][t] * kt[0][s] + qt[1][t] * kt[1][s]); if (lane == t * 8 + s) mine = v; } }
    WSP(float, SM_PS)[(size_t)item * 64 + lane] = mine;
}
__device__ __forceinline__ void phase2a(const Ctx& C) {
    for (int item = C.bx; item < 1024; item += C.G) p2a_prompt_item(C, item);
    for (int item = C.bx * 8 + C.wave; item < 512; item += C.G * 8) p2a_sample_item(C, item);
}
constexpr int SC_BUF = 40960, SC_OT = 81920;
__device__ __forceinline__ void p2b_stage(const Ctx& C, int item, int bufoff) {
    const unsigned char* pf = (const unsigned char*)WSP(bf16, WS_PF) + (size_t)item * 8192;
    const unsigned char* qf = (const unsigned char*)WSP(bf16, WS_QF) + (size_t)item * 16384;
    const unsigned char* kf = (const unsigned char*)WSP(bf16, WS_KF) + (size_t)item * 16384;
#pragma unroll
    for (int k = 0; k < 5; ++k) { const int q = C.wave * 5 + k;
        const unsigned char* src = q < 8 ? pf + q * 1024 : (q < 24 ? qf + (q - 8) * 1024 : kf + (q - 24) * 1024);
        __builtin_amdgcn_global_load_lds((const unsigned*)(src + C.lane * 16), (LAS unsigned*)(C.lds + bufoff + q * 1024), 16, 0, 0); }
}
__device__ __forceinline__ void p2b_scan(const Ctx& C, int bh, int half) {
    const int lane = C.lane, wave = C.wave, i = lane & 15, g = lane >> 4;
    const int b = bh >> 2, h = bh & 3, item0 = bh * 32;
    const int vcol = h * 256 + half * 128 + wave * 16 + i;
    const bf16* vrow = WSP(bf16, WS_VT) + (size_t)vcol * M + (size_t)b * 2048 + 4 * g;
    const float* EL = WSP(float, SM_EL) + (size_t)item0 * 128 + 4 * g;
    LAS unsigned char* L = C.lds; LAS unsigned char* ot = L + SC_OT + wave * 2048;
    f32x4 S[8];
#pragma unroll
    for (int dt = 0; dt < 8; ++dt) S[dt] = (f32x4){0.f, 0.f, 0.f, 0.f};
    u32x2 va[4], vn[4]; f32x4 el[8], eln[8];
    p2b_stage(C, item0, 0);
#pragma unroll
    for (int k = 0; k < 4; ++k) va[k] = *(const u32x2*)(vrow + 16 * k);
#pragma unroll
    for (int dt = 0; dt < 8; ++dt) el[dt] = *(const f32x4*)(EL + 16 * dt);
    for (int c = 0; c < 32; ++c) {
        VM_WAIT(); __builtin_amdgcn_s_barrier(); asm volatile("" ::: "memory");
        const int bo = (c & 1) * SC_BUF;
        if (c + 1 < 32) {
#pragma unroll
            for (int k = 0; k < 4; ++k) vn[k] = *(const u32x2*)(vrow + 64 * (c + 1) + 16 * k);
#pragma unroll
            for (int dt = 0; dt < 8; ++dt) eln[dt] = *(const f32x4*)(EL + (size_t)(c + 1) * 128 + 16 * dt);
            p2b_stage(C, item0 + c + 1, SC_BUF - bo);
        }
        bf16x8 vf[2], sf[4];
        vf[0] = __builtin_bit_cast(bf16x8, ((u32x4){va[0].x, va[0].y, va[1].x, va[1].y})); vf[1] = __builtin_bit_cast(bf16x8, ((u32x4){va[2].x, va[2].y, va[3].x, va[3].y}));
#pragma unroll
        for (int kd = 0; kd < 4; ++kd) sf[kd] = pack8(S[2 * kd], S[2 * kd + 1]);
        f32x4 o[4];
#pragma unroll
        for (int tt = 0; tt < 4; ++tt) { o[tt] = (f32x4){0.f, 0.f, 0.f, 0.f};
#pragma unroll
            for (int ks = 0; ks < 2; ++ks) o[tt] = MFMA16(*(const LAS bf16x8*)(L + bo + ((tt * 2 + ks) * 64 + lane) * 16), vf[ks], o[tt]);
#pragma unroll
            for (int kd = 0; kd < 4; ++kd) o[tt] = MFMA16(*(const LAS bf16x8*)(L + bo + 8192 + ((tt * 4 + kd) * 64 + lane) * 16), sf[kd], o[tt]); }
#pragma unroll
        for (int dt = 0; dt < 8; ++dt) {
#pragma unroll
            for (int ks = 0; ks < 2; ++ks) S[dt] = MFMA16(*(const LAS bf16x8*)(L + bo + 24576 + ((dt * 2 + ks) * 64 + lane) * 16), vf[ks], S[dt]);
            S[dt] = S[dt] * el[dt]; }
#pragma unroll
        for (int tt = 0; tt < 4; ++tt)
#pragma unroll
            for (int r = 0; r < 4; ++r) *(LAS unsigned short*)(ot + ((16 * tt + 4 * g + r) * 16 + i) * 2) = (unsigned short)(pk2(o[tt][r], 0.f) & 0xffffu);
        const u32x4 w0 = *(const LAS u32x4*)(ot + lane * 32), w1 = *(const LAS u32x4*)(ot + lane * 32 + 16);
        const unsigned ww[8] = {w0.x, w0.y, w0.z, w0.w, w1.x, w1.y, w1.z, w1.w}; float ss = 0.f;
#pragma unroll
        for (int j = 0; j < 8; ++j) { const float a = bflo(ww[j]), bq = bfhi(ww[j]); ss += a * a + bq * bq; }
        const size_t row = (size_t)b * 2048 + 64 * c + lane;
        bf16* op = WSP(bf16, WS_O) + row * 1024 + h * 256 + half * 128 + wave * 16;
        *(u32x4*)op = w0; *(u32x4*)(op + 8) = w1;
        WSP(float, SM_OSSQ)[row * 64 + h * 16 + half * 8 + wave] = ss;
        if (c + 1 < 32) {
#pragma unroll
            for (int k = 0; k < 4; ++k) va[k] = vn[k];
#pragma unroll
            for (int dt = 0; dt < 8; ++dt) el[dt] = eln[dt]; }
    }
    float* sp = C.out + OUT_SP + ((size_t)bh * 128) * 256 + half * 128 + wave * 16 + i;
#pragma unroll
    for (int dt = 0; dt < 8; ++dt)
#pragma unroll
        for (int r = 0; r < 4; ++r) sp[(size_t)(16 * dt + 4 * g + r) * 256] = S[dt][r];
    __syncthreads();
}
__device__ __forceinline__ void p2b_sample_unit(const Ctx& C, int u, LAS unsigned char* wl) {
    const int lane = C.lane, item = u >> 1, vh = u & 1, b = item >> 2, h = item & 3;
    LAS float* qs = (LAS float*)wl; LAS float* ks = qs + 1024; LAS float* els = qs + 2048; LAS float* ps = qs + 2176;
#pragma unroll
    for (int k = 0; k < 4; ++k) { ((LAS f32x4*)qs)[lane + 64 * k] = ((const f32x4*)(WSP(float, SM_QS) + (size_t)item * 1024))[lane + 64 * k];
                                  ((LAS f32x4*)ks)[lane + 64 * k] = ((const f32x4*)(WSP(float, SM_KS) + (size_t)item * 1024))[lane + 64 * k]; }
    if (lane < 32) ((LAS f32x4*)els)[lane] = ((const f32x4*)(WSP(float, SM_ELS) + (size_t)item * 128))[lane];
    if (lane < 16) ((LAS f32x4*)ps)[lane] = ((const f32x4*)(WSP(float, SM_PS) + (size_t)item * 64))[lane];
    float vs[2][8];
#pragma unroll
    for (int e = 0; e < 2; ++e) { const u32x4 w = *(const u32x4*)(WSP(bf16, WS_VT) + (size_t)(h * 256 + 128 * vh + 2 * lane + e) * M + MP + 8 * b);
        vs[e][0] = bflo(w.x); vs[e][1] = bfhi(w.x); vs[e][2] = bflo(w.y); vs[e][3] = bfhi(w.y); vs[e][4] = bflo(w.z); vs[e][5] = bfhi(w.z); vs[e][6] = bflo(w.w); vs[e][7] = bfhi(w.w); }
    float o[8][2];
#pragma unroll
    for (int t = 0; t < 8; ++t) { o[t][0] = 0.f; o[t][1] = 0.f; }
    const float* s0p = C.state + ((size_t)item * 128) * 256 + 128 * vh + 2 * lane;
    float* snp = C.out + OUT_SS + ((size_t)item * 128) * 256 + 128 * vh + 2 * lane;
    LDS_WAIT(); asm volatile("" ::: "memory");
#pragma unroll 8
    for (int d = 0; d < 128; ++d) {
        const f32x2 s0 = __builtin_nontemporal_load((const f32x2*)(s0p + (size_t)d * 256));
        const f32x4 qa = *(const LAS f32x4*)(qs + 8 * d), qb = *(const LAS f32x4*)(qs + 8 * d + 4), ka = *(const LAS f32x4*)(ks + 8 * d), kb = *(const LAS f32x4*)(ks + 8 * d + 4);
        const float el = els[d];
        const float q8[8] = {qa.x, qa.y, qa.z, qa.w, qb.x, qb.y, qb.z, qb.w}, k8[8] = {ka.x, ka.y, ka.z, ka.w, kb.x, kb.y, kb.z, kb.w};
        float kv0 = 0.f, kv1 = 0.f;
#pragma unroll
        for (int s = 0; s < 8; ++s) { kv0 += k8[s] * vs[0][s]; kv1 += k8[s] * vs[1][s]; }
        f32x2 sn; sn.x = el * (s0.x + kv0); sn.y = el * (s0.y + kv1);
        __builtin_nontemporal_store(sn, (f32x2*)(snp + (size_t)d * 256));
#pragma unroll
        for (int t = 0; t < 8; ++t) { o[t][0] += q8[t] * s0.x; o[t][1] += q8[t] * s0.y; }
    }
    const size_t row0 = (size_t)MP + 8 * b;
#pragma unroll
    for (int t = 0; t < 8; ++t) {
#pragma unroll
        for (int s = 0; s < 8; ++s) if (s <= t) { const float p = ps[t * 8 + s]; o[t][0] += p * vs[0][s]; o[t][1] += p * vs[1][s]; }
        const unsigned w = pk2(o[t][0], o[t][1]);
        *(unsigned*)(WSP(bf16, WS_O) + (row0 + t) * 1024 + h * 256 + 128 * vh + 2 * lane) = w;
        const float a = bflo(w), bq = bfhi(w); const float ss = wave_sum(a * a + bq * bq);
        if (lane < 8) WSP(float, SM_OSSQ)[(row0 + t) * 64 + h * 16 + 8 * vh + lane] = (lane == 0) ? ss : 0.f;
    }
    LDS_WAIT(); asm volatile("" ::: "memory");
}
__device__ __forceinline__ void phase2b(const Ctx& C) {
    const int vb = (C.G % 8 == 0) ? (C.bx % 8) * (C.G / 8) + C.bx / 8 : C.bx;
    if ((vb & 3) == 0) { for (int su = vb >> 2; su < 64; su += (C.G + 3) / 4) p2b_scan(C, su >> 1, su & 1); }
    else { const int ni = (vb >> 2) * 3 + (vb & 3) - 1, NN = C.G - (C.G + 3) / 4;
        for (int u = C.wave * NN + ni; u < 1024; u += 8 * NN) p2b_sample_unit(C, u, C.lds + C.wave * 10240); }
}
__device__ __forceinline__ void phase2c(const Ctx& C) {
    const int lane = C.lane, hd = lane >> 4, c0 = 16 * lane;
    f32x4 gn[4];
#pragma unroll
    for (int k = 0; k < 4; ++k) gn[k] = *(const f32x4*)(C.gon + (c0 & 255) + 4 * k);
    for (int row = C.bx * 8 + C.wave; row < M; row += C.G * 8) {
        const float rs = rstd_from16(WSP(float, SM_OSSQ) + (size_t)row * 64 + hd * 16, 1.f / 256.f);
        bf16* op = WSP(bf16, WS_O) + (size_t)row * 1024 + c0; const bf16* gp = WSP(bf16, WS_G) + (size_t)row * 1024 + c0;
#pragma unroll
        for (int k = 0; k < 2; ++k) { const u32x4 ow = *(const u32x4*)(op + 8 * k), gw = *(const u32x4*)(gp + 8 * k);
            f32x4 a, bq;
            a.x = bflo(ow.x) * rs * gn[2 * k].x * bflo(gw.x); a.y = bfhi(ow.x) * rs * gn[2 * k].y * bfhi(gw.x); a.z = bflo(ow.y) * rs * gn[2 * k].z * bflo(gw.y); a.w = bfhi(ow.y) * rs * gn[2 * k].w * bfhi(gw.y);
            bq.x = bflo(ow.z) * rs * gn[2 * k + 1].x * bflo(gw.z); bq.y = bfhi(ow.z) * rs * gn[2 * k + 1].y * bfhi(gw.z); bq.z = bflo(ow.w) * rs * gn[2 * k + 1].z * bflo(gw.w); bq.w = bfhi(ow.w) * rs * gn[2 * k + 1].w * bfhi(gw.w);
            *(u32x4*)(op + 8 * k) = pack8u(a, bq); }
    }
}
template <bool FINAL>
__device__ __forceinline__ void outproj_tail(const Ctx& C, const bf16* A, const bf16* Bt, const float* base, float* XO, bf16* XOB, float* SSQP) {
    const int lane = C.lane, wave = C.wave, i = lane & 15, g = lane >> 4;
    LAS float* red = (LAS float*)C.lds;
    for (int bt = C.bx; bt < 64; bt += C.G) {
        f32x4 acc[1][4][2];
        tail_mma<1, 4>(A, Bt, 16 * bt, 128 * wave, 32, lane, acc);
        const int rl = 16 * bt + i; const size_t row = (size_t)MP + rl; float ss = 0.f;
#pragma unroll
        for (int ng = 0; ng < 4; ++ng)
#pragma unroll
            for (int n = 0; n < 2; ++n) { const int col = 128 * wave + 32 * ng + 8 * g + 4 * n;
                const f32x4 v = acc[0][ng][n] + *(const f32x4*)(base + (size_t)rl * 1024 + col); acc[0][ng][n] = v; ss += (v.x * v.x + v.y * v.y) + (v.z * v.z + v.w * v.w); }
        ss += __shfl_xor(ss, 16); ss += __shfl_xor(ss, 32);
        if (!FINAL) {
#pragma unroll
            for (int ng = 0; ng < 4; ++ng)
#pragma unroll
                for (int n = 0; n < 2; ++n) { const size_t off = row * 1024 + 128 * wave + 32 * ng + 8 * g + 4 * n; const f32x4 v = acc[0][ng][n];
                    *(f32x4*)(XO + off) = v; u32x2 w; w.x = pk2(v.x, v.y); w.y = pk2(v.z, v.w); *(u32x2*)(XOB + off) = w; }
            if (g == 0) SSQP[row * 16 + wave] = ss; if (g == 1) SSQP[row * 16 + 8 + wave] = 0.f;
        } else {
            if (g == 0) red[wave * 16 + i] = ss;
            __syncthreads();
            float tot = 0.f;
#pragma unroll
            for (int w = 0; w < 8; ++w) tot += red[w * 16 + i];
            const float rs = rsqrtf(tot * (1.f / 1024.f) + 1e-6f);
#pragma unroll
            for (int ng = 0; ng < 4; ++ng)
#pragma unroll
                for (int n = 0; n < 2; ++n) { const int col = 128 * wave + 32 * ng + 8 * g + 4 * n; const f32x4 nfv = *(const f32x4*)(C.nf + col);
                    *(f32x4*)(XO + row * 1024 + col) = acc[0][ng][n] * rs * nfv; }
            __syncthreads();
        }
    }
}
__device__ __forceinline__ void phase3(const Ctx& C) {
    float* X1 = C.out + OUT_YP;
    { pg8::Gemm g{WSP(bf16, WS_O), WSP(bf16, WS_WO1), MP, 1024, 1024}; pg8::StaticOrder S; S.init(MP, 1024, C.G, C.bx);
      EpiRes<true> E{C.xp, X1, WSP(bf16, WS_X1B), WSP(float, SM_SSQ1P)};
      pg8::gemm_phase<EpiRes<true>, pg8::StaticOrder, MK_ALIGN, MK_SP2>(C.lds, g, S, E); }
    outproj_tail<false>(C, WSP(bf16, WS_O) + (size_t)MP * 1024, WSP(bf16, WS_WO1), C.xs, X1, WSP(bf16, WS_X1B), WSP(float, SM_SSQ1P));
}
__device__ __forceinline__ void phase6(const Ctx& C) {
    float* X1 = C.out + OUT_YP;
    { pg8::Gemm g{WSP(bf16, WS_Z), WSP(bf16, WS_WO2), MP, 1024, 1024}; pg8::StaticOrder S; S.init(MP, 1024, C.G, C.bx);
      EpiRes<false> E{X1, X1, nullptr, WSP(float, SM_SSQ2P)};
      pg8::gemm_phase<EpiRes<false>, pg8::StaticOrder, MK_ALIGN, MK_SP2>(C.lds, g, S, E); }
    outproj_tail<true>(C, WSP(bf16, WS_Z) + (size_t)MP * 1024, WSP(bf16, WS_WO2), X1 + (size_t)MP * 1024, X1, nullptr, nullptr);
}
__device__ __forceinline__ void phase4(const Ctx& C) {
    { pg8::Gemm g{WSP(bf16, WS_X1B), WSP(bf16, WS_W2UG), MP, 2048, 1024}; pg8::StaticOrder S; S.init(MP, 2048, C.G, C.bx);
      Wrap8P<EpiUG> E{{WSP(float, SM_SSQ1P), WSP(bf16, WS_UG)}};
      pg8::gemm_phase<Wrap8P<EpiUG>, pg8::StaticOrder, MK_ALIGN, MK_SP2>(C.lds, g, S, E); }
    { pg8::Gemm g{WSP(bf16, WS_W2V), WSP(bf16, WS_X1B), 1024, MP, 1024}; pg8::StaticOrder S; S.init(1024, MP, C.G, C.bx);
      EpiVT2 E{WSP(bf16, WS_VT2), WSP(f32x2, SM_VSTAT)};
      pg8::gemm_phase<EpiVT2, pg8::StaticOrder, MK_ALIGN, MK_SP2>(C.lds, g, S, E); }
    for (int t = C.bx; t < 256; t += C.G) {
        if (t < 128) { const EpiUG e{WSP(float, SM_SSQ1P), WSP(bf16, WS_UG)};
            tail_tile_pair(WSP(bf16, WS_X1B) + (size_t)MP * 1024, WSP(bf16, WS_W2UG), t >> 3, t & 7, MP, C.wave, C.lane, e); }
        else { const int u = t - 128; const EpiVT2raw e{WSP(bf16, WS_VT2)};
            tail_tile_p8(WSP(bf16, WS_W2V), WSP(bf16, WS_X1B) + (size_t)MP * 1024, u >> 3, u & 7, 0, MP, C.wave, C.lane, e); }
    }
}
constexpr int P5_RS = 0, P5_RM = 512, P5_C1 = 1024;
__device__ __forceinline__ void p5_prompt_item(const Ctx& C, int item) {
    const int tid = C.tid, lane = C.lane, wave = C.wave, i = lane & 15, g = lane >> 4;
    const int b = item >> 6, n = (item >> 2) & 15, gr = item & 3, T0 = b * 2048 + 128 * n, C0 = 256 * gr;
    LAS float* RS = (LAS float*)(C.lds + P5_RS); LAS float* RM = (LAS float*)(C.lds + P5_RM); LAS float* C1 = (LAS float*)(C.lds + P5_C1);
    if (tid < 128) { const size_t tok = (size_t)T0 + tid; const f32x2* vs = WSP(f32x2, SM_VSTAT) + tok * 8; float s = 0.f, q = 0.f;
#pragma unroll
        for (int k = 0; k < 8; ++k) { const f32x2 p = vs[k]; s += p.x; q += p.y; }
        const float* sp = WSP(float, SM_SSQ1P) + tok * 16; float s1 = 0.f;
#pragma unroll
        for (int k = 0; k < 16; ++k) s1 += sp[k];
        const float mean = s * (1.f / 1024.f), var = fmaxf(q * (1.f / 1024.f) - mean * mean, 0.f), ms1 = s1 * (1.f / 1024.f) + 1e-6f;
        const float rs = rsqrtf(var + 1e-6f * ms1); RS[tid] = rs; RM[tid] = rs * mean; }
    __syncthreads();
    { const int t = tid >> 2, q4 = tid & 3; const float* wr = C.wsp + ((size_t)gr * 128 + t) * 128 + 32 * q4; float s = 0.f;
#pragma unroll
      for (int k = 0; k < 8; ++k) { const f32x4 w = *(const f32x4*)(wr + 4 * k); const f32x4 m = *(const LAS f32x4*)(RM + 32 * q4 + 4 * k); const int s0 = 32 * q4 + 4 * k;
          s += (s0 <= t ? w.x * m.x : 0.f) + (s0 + 1 <= t ? w.y * m.y : 0.f) + (s0 + 2 <= t ? w.z * m.z : 0.f) + (s0 + 3 <= t ? w.w * m.w : 0.f); }
      s += __shfl_xor(s, 1); s += __shfl_xor(s, 2); if (q4 == 0) C1[t] = s; }
    __syncthreads();
    bf16x8 vf[2][4];
#pragma unroll
    for (int nn = 0; nn < 2; ++nn) { const int ch = C0 + 32 * wave + 8 * (i >> 2) + 4 * nn + (i & 3); const bf16* vp = WSP(bf16, WS_VT2) + (size_t)ch * M + T0 + 8 * g;
#pragma unroll
        for (int ks = 0; ks < 4; ++ks) { const u32x4 w = *(const u32x4*)(vp + 32 * ks); const f32x4 r0 = *(const LAS f32x4*)(RS + 32 * ks + 8 * g), r1 = *(const LAS f32x4*)(RS + 32 * ks + 8 * g + 4);
            f32x4 a, c; a.x = bflo(w.x) * r0.x; a.y = bfhi(w.x) * r0.y; a.z = bflo(w.y) * r0.z; a.w = bfhi(w.y) * r0.w; c.x = bflo(w.z) * r1.x; c.y = bfhi(w.z) * r1.y; c.z = bflo(w.w) * r1.z; c.w = bfhi(w.w) * r1.w;
            vf[nn][ks] = pack8(a, c); } }
    const int ch0 = C0 + 32 * wave + 8 * g;
    const f32x4 lg0 = *(const f32x4*)(C.lng + ch0), lg1 = *(const f32x4*)(C.lng + ch0 + 4), lb0 = *(const f32x4*)(C.lnb + ch0), lb1 = *(const f32x4*)(C.lnb + ch0 + 4);
    const bf16* wsb = WSP(bf16, SM_WSB) + (size_t)gr * 16384;
#pragma unroll
    for (int tt = 0; tt < 8; ++tt) {
        f32x4 a0 = {0.f, 0.f, 0.f, 0.f}, a1 = {0.f, 0.f, 0.f, 0.f};
#pragma unroll
        for (int ks = 0; ks <= (tt >> 1); ++ks) { const bf16x8 wf = *(const bf16x8*)(wsb + (16 * tt + i) * 128 + 32 * ks + 8 * g);
            a0 = MFMA16(vf[0][ks], wf, a0); a1 = MFMA16(vf[1][ks], wf, a1); }
        const int t = 16 * tt + i; const size_t row = (size_t)T0 + t;
        const float c1 = C1[t], c2 = WSP(float, SM_C2)[gr * 128 + t], bs = C.bsp[gr * 128 + t];
        const u32x4 ug = *(const u32x4*)(WSP(bf16, WS_UG) + row * 1024 + ch0);
        f32x4 z0, z1;
        z0.x = bflo(ug.x) * (lg0.x * (a0.x - c1) + lb0.x * c2 + bs); z0.y = bfhi(ug.x) * (lg0.y * (a0.y - c1) + lb0.y * c2 + bs); z0.z = bflo(ug.y) * (lg0.z * (a0.z - c1) + lb0.z * c2 + bs); z0.w = bfhi(ug.y) * (lg0.w * (a0.w - c1) + lb0.w * c2 + bs);
        z1.x = bflo(ug.z) * (lg1.x * (a1.x - c1) + lb1.x * c2 + bs); z1.y = bfhi(ug.z) * (lg1.y * (a1.y - c1) + lb1.y * c2 + bs); z1.z = bflo(ug.w) * (lg1.z * (a1.z - c1) + lb1.z * c2 + bs); z1.w = bfhi(ug.w) * (lg1.w * (a1.w - c1) + lb1.w * c2 + bs);
        *(u32x4*)(WSP(bf16, WS_Z) + row * 1024 + ch0) = pack8u(z0, z1);
    }
    __syncthreads();
}
__device__ __forceinline__ void p5_sample_item(const Ctx& C, int item) {
    const int lane = C.lane, b = item >> 2, gr = item & 3, T0 = MP + 8 * b;
    float sm[8], sq[8];
#pragma unroll
    for (int s = 0; s < 8; ++s) { sm[s] = 0.f; sq[s] = 0.f; }
#pragma unroll 4
    for (int k = 0; k < 16; ++k) { const u32x4 w = *(const u32x4*)(WSP(bf16, WS_VT2) + (size_t)(lane + 64 * k) * M + T0);
        const float v[8] = {bflo(w.x), bfhi(w.x), bflo(w.y), bfhi(w.y), bflo(w.z), bfhi(w.z), bflo(w.w), bfhi(w.w)};
#pragma unroll
        for (int s = 0; s < 8; ++s) { sm[s] += v[s]; sq[s] += v[s] * v[s]; } }
    float rs[8], mu[8];
#pragma unroll
    for (int s = 0; s < 8; ++s) { const float a = wave_sum(sm[s]), q = wave_sum(sq[s]); const float* sp = WSP(float, SM_SSQ1P) + (size_t)(T0 + s) * 16; float s1 = 0.f;
#pragma unroll
        for (int k = 0; k < 16; ++k) s1 += sp[k];
        const float mean = a * (1.f / 1024.f), var = fmaxf(q * (1.f / 1024.f) - mean * mean, 0.f), ms1 = s1 * (1.f / 1024.f) + 1e-6f;
        mu[s] = mean; rs[s] = rsqrtf(var + 1e-6f * ms1); }
    const int ch0 = 256 * gr + 4 * lane;
    const f32x4 lg = *(const f32x4*)(C.lng + ch0), lb = *(const f32x4*)(C.lnb + ch0);
    float vn[4][8];
#pragma unroll
    for (int e = 0; e < 4; ++e) { const u32x4 w = *(const u32x4*)(WSP(bf16, WS_VT2) + (size_t)(ch0 + e) * M + T0);
        const float v[8] = {bflo(w.x), bfhi(w.x), bflo(w.y), bfhi(w.y), bflo(w.z), bfhi(w.z), bflo(w.w), bfhi(w.w)};
#pragma unroll
        for (int s = 0; s < 8; ++s) vn[e][s] = (v[s] - mu[s]) * rs[s] * lg[e] + lb[e]; }
#pragma unroll
    for (int t = 0; t < 8; ++t) {
        *(f32x4*)(C.out + OUT_VS + ((size_t)(8 * b + t)) * 1024 + ch0) = (f32x4){vn[0][t], vn[1][t], vn[2][t], vn[3][t]};
        float m[4]; const float bs = C.bsp[gr * 128 + t];
#pragma unroll
        for (int e = 0; e < 4; ++e) m[e] = bs;
#pragma unroll
        for (int s = 0; s < 8; ++s) if (s <= t) { const float w = C.wsp[((size_t)gr * 128 + t) * 128 + s];
#pragma unroll
            for (int e = 0; e < 4; ++e) m[e] += w * vn[e][s]; }
        const u32x2 ug = *(const u32x2*)(WSP(bf16, WS_UG) + (size_t)(T0 + t) * 1024 + ch0);
        u32x2 z; z.x = pk2(bflo(ug.x) * m[0], bfhi(ug.x) * m[1]); z.y = pk2(bflo(ug.y) * m[2], bfhi(ug.y) * m[3]);
        *(u32x2*)(WSP(bf16, WS_Z) + (size_t)(T0 + t) * 1024 + ch0) = z;
    }
}
__device__ __forceinline__ void phase5(const Ctx& C) {
    for (int item = C.bx; item < 512; item += C.G) p5_prompt_item(C, item);
    for (int item = C.bx * 8 + C.wave; item < 512; item += C.G * 8) p5_sample_item(C, item);
}
__device__ __forceinline__ void phase7(const Ctx& C) {
    const int lane = C.lane; f32x4 nfv[4];
#pragma unroll
    for (int j = 0; j < 4; ++j) nfv[j] = *(const f32x4*)(C.nf + 4 * lane + 256 * j);
    for (int row = C.bx * 8 + C.wave; row < MP; row += C.G * 8) {
        const float rs = rstd_from16(WSP(float, SM_SSQ2P) + (size_t)row * 16, 1.f / 1024.f);
        f32x4* p = (f32x4*)(C.out + OUT_YP + (size_t)row * 1024) + lane;
#pragma unroll
        for (int j = 0; j < 4; ++j) p[64 * j] = p[64 * j] * rs * nfv[j];
    }
}
constexpr int NPHASE = 10;
struct Args { const float* in[16]; float* out; unsigned char* ws; int ph_lo, ph_hi; };
__global__ void __launch_bounds__(512, 2) mk_fwd(Args a) {
    extern __shared__ __attribute__((aligned(16))) unsigned char lds_raw[];
    Ctx C;
    C.lds = (LAS unsigned char*)lds_raw;
    C.tid = threadIdx.x; C.lane = C.tid & 63; C.wave = __builtin_amdgcn_readfirstlane(C.tid >> 6); C.G = gridDim.x; C.bx = blockIdx.x;
    C.xp = a.in[0]; C.xs = a.in[1]; C.state = a.in[2]; C.norm_g = a.in[3]; C.w_in = a.in[4]; C.wup = a.in[5]; C.bup = a.in[6]; C.gon = a.in[7]; C.w_out = a.in[8];
    C.cw_in = a.in[9]; C.lng = a.in[10]; C.lnb = a.in[11]; C.wsp = a.in[12]; C.bsp = a.in[13]; C.cw_out = a.in[14]; C.nf = a.in[15]; C.out = a.out; C.ws = a.ws;
    volatile LAS unsigned* MISC = (volatile LAS unsigned*)(C.lds + MISC_OFF);
    for (int u = C.tid; u < (LDS_BYTES - MISC_OFF) / 4; u += 512) MISC[u] = 0u;
    __syncthreads();
    const int lo = a.ph_lo, hi = a.ph_hi;
    XcdBarrier bar; bar.bar = (unsigned*)(C.ws + WS_CTL) + CW_BAR; bar.x = 0; bar.st = nullptr;
    if (hi - lo > 1) bar = xcd_barrier_post((unsigned*)(C.ws + WS_CTL) + CW_BAR, MISC + 8);
#define IN(k) (lo <= (k) && (k) < hi)
#define SEAM(k) do { if (IN(k) && IN((k) + 1)) xcd_barrier(bar); } while (0)
    if (IN(0)) phase0(C);  SEAM(0);
    if (IN(1)) phase1(C);  SEAM(1);
    if (IN(2)) phase2a(C); SEAM(2);
    if (IN(3)) phase2b(C); SEAM(3);
    if (IN(4)) phase2c(C); SEAM(4);
    if (IN(5)) phase3(C);  SEAM(5);
    if (IN(6)) phase4(C);  SEAM(6);
    if (IN(7)) phase5(C);  SEAM(7);
    if (IN(8)) phase6(C);  SEAM(8);
    if (IN(9)) phase7(C);
#undef IN
#undef SEAM
}
static int mk_grid() {
    static int grid = 0;
    if (grid == 0) {
        int dev = 0, cus = 0;
        if (hipGetDevice(&dev) != hipSuccess || hipDeviceGetAttribute(&cus, hipDeviceAttributeMultiprocessorCount, dev) != hipSuccess) { fprintf(stderr, "mk: device query failed\n"); grid = -1; return grid; }
        if (hipFuncSetAttribute((const void*)mk_fwd, hipFuncAttributeMaxDynamicSharedMemorySize, LDS_BYTES) != hipSuccess) { fprintf(stderr, "mk: hipFuncSetAttribute failed\n"); grid = -1; return grid; }
        int per_cu = 0; (void)hipOccupancyMaxActiveBlocksPerMultiprocessor(&per_cu, (const void*)mk_fwd, 512, LDS_BYTES); (void)hipGetLastError();
        if (per_cu < 1) fprintf(stderr, "mk: occupancy query reports %d blocks per CU\n", per_cu);
        grid = cus;
    }
    return grid;
}
static void mk_launch(void* const* d_in, void* d_out, void* d_ws, hipStream_t stream, int lo, int hi) {
    const int grid = mk_grid(); if (grid <= 0) return;
    Args a{};
    for (int i = 0; i < 16; ++i) a.in[i] = (const float*)d_in[i];
    a.out = (float*)d_out; a.ws = (unsigned char*)d_ws; a.ph_lo = lo; a.ph_hi = hi;
    hipLaunchKernelGGL(mk_fwd, dim3(grid), dim3(512), LDS_BYTES, stream, a);
}
}
#ifndef MK_MODE
#define MK_MODE 0
#endif
extern "C" void kernel_launch(void* const* d_in, const int* in_sizes, int n_in, void* d_out, int out_size, void* d_ws, size_t ws_size, hipStream_t stream) {
    (void)in_sizes; (void)n_in; (void)out_size; (void)ws_size;
    (void)hipMemsetAsync((char*)d_ws + mk::WS_CTL, 0, mk::CTL_ZERO_BYTES, stream);
#if MK_MODE == 0
    mk::mk_launch(d_in, d_out, d_ws, stream, 0, mk::NPHASE);
#else
#ifndef DBG_UPTO
#define DBG_UPTO 10
#endif
    for (int p = 0; p < DBG_UPTO; ++p) mk::mk_launch(d_in, d_out, d_ws, stream, p, p + 1);
#if MK_MODE == 2
    dbg::forward(d_in, (float*)d_out, (unsigned char*)d_ws, stream);
#endif
#endif
}
```
